# Optimizing an MI355X kernel written in HIP

```python
import math
import jax, jax.numpy as jnp
from jax import lax
import numpy as np

D_MODEL = 1024
BATCH = 1
SEQ = 16384
DEPTH = 2

ATT_HEADS = 8
ATT_KV_HEADS = 2
HEAD_DIM = 64
WINDOW = 128
ROT_DIM = HEAD_DIM // 4
ROPE_THETA = 500000.0
SGU_GROUPS = 8
SGU_GROUP_DIM = 64
CHUNK = 128
CONV_WIDTH = 3
CONV_DIM = D_MODEL
D_FF = 2816
PLE_DIM = 256

N_EVEN = (DEPTH + 1) // 2
N_ODD = DEPTH // 2
ALPHA = (2 * DEPTH) ** 0.25
BETA = (8 * DEPTH) ** -0.25
LN_EPS = 1e-5

Q_W = ATT_HEADS * HEAD_DIM
KV_W = ATT_KV_HEADS * HEAD_DIM
SGU_W = SGU_GROUPS * SGU_GROUP_DIM
AB_IN = Q_W + 2 * KV_W + 2 * SGU_W
AB_OUT = Q_W + SGU_W

kernel_name = "hybrid_gmlp_swa_shortconv_deepnorm"


def layer_norm(x, g, b):
    xf = x.astype(jnp.float32)
    mu = jnp.mean(xf, axis=-1, keepdims=True)
    var = jnp.mean(jnp.square(xf - mu), axis=-1, keepdims=True)
    y = (xf - mu) * lax.rsqrt(var + LN_EPS)
    return (y * g.astype(jnp.float32) + b.astype(jnp.float32)).astype(x.dtype)


def swiglu(x, w_gate, w_up, w_down):
    return (jax.nn.silu(x @ w_gate) * (x @ w_up)) @ w_down


def partial_rotary(x, positions):
    half = ROT_DIM // 2
    inv = jnp.power(ROPE_THETA, -jnp.arange(half, dtype=jnp.float32) * (2.0 / ROT_DIM))
    ang = positions.astype(jnp.float32)[..., None] * inv
    cos = jnp.cos(ang)[:, :, None, :]
    sin = jnp.sin(ang)[:, :, None, :]
    xf = x.astype(jnp.float32)
    x1 = xf[..., :half]
    x2 = xf[..., half:ROT_DIM]
    rot = jnp.concatenate([x1 * cos - x2 * sin, x2 * cos + x1 * sin, xf[..., ROT_DIM:]], axis=-1)
    return rot.astype(x.dtype)


def sliding_window_sink_attention(q, k, v, sinks):
    b, s = q.shape[0], q.shape[1]
    nb = s // WINDOW
    g = ATT_HEADS // ATT_KV_HEADS
    qb = q.reshape(b, nb, WINDOW, ATT_KV_HEADS, g, HEAD_DIM)

    def band(t):
        tb = t.reshape(b, nb, WINDOW, ATT_KV_HEADS, HEAD_DIM)
        prev = jnp.pad(tb, ((0, 0), (1, 0), (0, 0), (0, 0), (0, 0)))[:, :-1]
        return jnp.concatenate([prev, tb], axis=2)

    kb, vb = band(k), band(v)
    scores = jnp.einsum('bnqhgd,bnkhd->bnhgqk', qb, kb).astype(jnp.float32) * (HEAD_DIM ** -0.5)
    qi = jnp.arange(WINDOW)[:, None]
    kj = jnp.arange(2 * WINDOW)[None, :]
    diff = qi + WINDOW - kj
    blk = jnp.arange(nb)[:, None, None]
    valid = (diff >= 0) & (diff < WINDOW) & (blk * WINDOW + kj - WINDOW >= 0)
    scores = jnp.where(valid[None, :, None, None], scores, -1e30)
    sink = jnp.broadcast_to(sinks.astype(jnp.float32).reshape(1, 1, ATT_KV_HEADS, g, 1, 1),
                            scores.shape[:-1] + (1,))
    probs = jax.nn.softmax(jnp.concatenate([scores, sink], axis=-1), axis=-1)[..., :-1]
    out = jnp.einsum('bnhgqk,bnkhd->bnqhgd', probs.astype(vb.dtype), vb)
    return out.reshape(b, s, ATT_HEADS * HEAD_DIM)


def chunked_sgu(u, v, ln_g, ln_b, w_s, b_s):
    b, s = u.shape[0], u.shape[1]
    nc = s // CHUNK
    u = jax.nn.gelu(u)
    v = layer_norm(jax.nn.gelu(v), ln_g, ln_b)
    vc = v.reshape(b, nc, CHUNK, SGU_GROUPS, SGU_GROUP_DIM)
    w = w_s * jnp.tril(jnp.ones((CHUNK, CHUNK), dtype=w_s.dtype))
    mixed = jnp.einsum('gts,bcsgd->bctgd', w, vc) + jnp.transpose(b_s)[None, None, :, :, None]
    return u * mixed.reshape(b, s, SGU_W)


def short_conv_mixer(x, w_in, conv_w, w_out):
    s = x.shape[1]
    gate_b, gate_c, z = jnp.split(x @ w_in, 3, axis=-1)
    zp = jnp.pad(gate_c * z, ((0, 0), (CONV_WIDTH - 1, 0), (0, 0)))
    y = conv_w[0] * zp[:, 0:s]
    for t in range(1, CONV_WIDTH):
        y = y + conv_w[t] * zp[:, t:t + s]
    return (gate_b * y) @ w_out


def setup_inputs(seed: int = 0) -> dict:
    key = jax.random.key(seed)
    ks = jax.random.split(key, 24)
    nrm = jax.random.normal
    f32 = jnp.float32
    x = nrm(ks[0], (BATCH, SEQ, D_MODEL), f32)
    p = nrm(ks[1], (DEPTH, BATCH, SEQ, PLE_DIM), f32)
    offset = jax.random.randint(ks[2], (BATCH, 1), 0, 4096, dtype=jnp.int32)
    positions = offset + jnp.arange(SEQ, dtype=jnp.int32)[None, :]
    ln_g = 1.0 + 0.02 * nrm(ks[3], (DEPTH, 3, D_MODEL), f32)
    ln_b = 0.02 * nrm(ks[4], (DEPTH, 3, D_MODEL), f32)
    ffn_w_gate = nrm(ks[5], (DEPTH, 2, D_MODEL, D_FF), f32) * D_MODEL ** -0.5
    ffn_w_up = nrm(ks[6], (DEPTH, 2, D_MODEL, D_FF), f32) * D_MODEL ** -0.5
    ffn_w_down = nrm(ks[7], (DEPTH, 2, D_FF, D_MODEL), f32) * (D_FF ** -0.5 * BETA)
    ab_w_in = nrm(ks[8], (N_EVEN, D_MODEL, AB_IN), f32) * D_MODEL ** -0.5
    ab_sinks = nrm(ks[9], (N_EVEN, ATT_HEADS), f32)
    sgu_ln_g = 1.0 + 0.02 * nrm(ks[10], (N_EVEN, SGU_W), f32)
    sgu_ln_b = 0.02 * nrm(ks[11], (N_EVEN, SGU_W), f32)
    sgu_w_s = nrm(ks[12], (N_EVEN, SGU_GROUPS, CHUNK, CHUNK), f32) * CHUNK ** -0.5
    sgu_b_s = 1.0 + 0.1 * nrm(ks[13], (N_EVEN, SGU_GROUPS, CHUNK), f32)
    ab_w_out = nrm(ks[14], (N_EVEN, AB_OUT, D_MODEL), f32) * (AB_OUT ** -0.5 * BETA)
    sc_w_in = nrm(ks[15], (N_ODD, D_MODEL, 3 * CONV_DIM), f32) * D_MODEL ** -0.5
    sc_conv_w = nrm(ks[16], (N_ODD, CONV_WIDTH, CONV_DIM), f32) * CONV_WIDTH ** -0.5
    sc_w_out = nrm(ks[17], (N_ODD, CONV_DIM, D_MODEL), f32) * (CONV_DIM ** -0.5 * BETA)
    ple_w_proj = nrm(ks[18], (DEPTH, PLE_DIM, D_MODEL), f32) * PLE_DIM ** -0.5
    ple_w_gate = nrm(ks[19], (DEPTH, D_MODEL, D_MODEL), f32) * D_MODEL ** -0.5
    return {"x": x, "p": p, "positions": positions, "ln_g": ln_g, "ln_b": ln_b,
            "ffn_w_gate": ffn_w_gate, "ffn_w_up": ffn_w_up, "ffn_w_down": ffn_w_down,
            "ab_w_in": ab_w_in, "ab_sinks": ab_sinks, "sgu_ln_g": sgu_ln_g, "sgu_ln_b": sgu_ln_b,
            "sgu_w_s": sgu_w_s, "sgu_b_s": sgu_b_s, "ab_w_out": ab_w_out,
            "sc_w_in": sc_w_in, "sc_conv_w": sc_conv_w, "sc_w_out": sc_w_out,
            "ple_w_proj": ple_w_proj, "ple_w_gate": ple_w_gate}


def reference(x, p, positions, ln_g, ln_b, ffn_w_gate, ffn_w_up, ffn_w_down,
              ab_w_in, ab_sinks, sgu_ln_g, sgu_ln_b, sgu_w_s, sgu_b_s, ab_w_out,
              sc_w_in, sc_conv_w, sc_w_out, ple_w_proj, ple_w_gate):
    b, s = x.shape[0], x.shape[1]
    g = ATT_HEADS // ATT_KV_HEADS
    splits = [Q_W, Q_W + KV_W, Q_W + 2 * KV_W, Q_W + 2 * KV_W + SGU_W]
    for i in range(DEPTH):
        ff1 = swiglu(x, ffn_w_gate[i, 0], ffn_w_up[i, 0], ffn_w_down[i, 0])
        x = layer_norm(ALPHA * x + 0.5 * ff1, ln_g[i, 0], ln_b[i, 0])
        j = i // 2
        if i % 2 == 0:
            h = x @ ab_w_in[j]
            q, k, v, su, sv = jnp.split(h, splits, axis=-1)
            q = partial_rotary(q.reshape(b, s, ATT_HEADS, HEAD_DIM), positions)
            q = q.reshape(b, s, ATT_KV_HEADS, g, HEAD_DIM)
            k = partial_rotary(k.reshape(b, s, ATT_KV_HEADS, HEAD_DIM), positions)
            v = v.reshape(b, s, ATT_KV_HEADS, HEAD_DIM)
            att = sliding_window_sink_attention(q, k, v, ab_sinks[j])
            sgu = chunked_sgu(su, sv, sgu_ln_g[j], sgu_ln_b[j], sgu_w_s[j], sgu_b_s[j])
            mix = jnp.concatenate([att, sgu], axis=-1) @ ab_w_out[j]
        else:
            mix = short_conv_mixer(x, sc_w_in[j], sc_conv_w[j], sc_w_out[j])
        x = layer_norm(ALPHA * x + mix, ln_g[i, 1], ln_b[i, 1])
        ff2 = swiglu(x, ffn_w_gate[i, 1], ffn_w_up[i, 1], ffn_w_down[i, 1])
        x = layer_norm(ALPHA * x + 0.5 * ff2, ln_g[i, 2], ln_b[i, 2])
        x = x + (p[i] @ ple_w_proj[i]) * jax.nn.sigmoid(x @ ple_w_gate[i])
    return x
```

```cpp
#include <hip/hip_runtime.h>
#include <hip/hip_cooperative_groups.h>
#include <cstdio>
#include <cstdint>
namespace cg = cooperative_groups;
namespace pg8 {
#define PG8_LAS __attribute__((address_space(3)))
typedef unsigned short bf16_t;
typedef short bf16x8 __attribute__((ext_vector_type(8)));
typedef float f32x4 __attribute__((ext_vector_type(4)));
typedef unsigned u32x4 __attribute__((ext_vector_type(4)));
constexpr int BM = 256, BK = 64, HALF = 128, HTB = HALF * BK * 2  , STAGE_BYTES = 8 * HTB, NXCD = 8, WGM = 8;

__host__ __device__ __forceinline__ int lds_byte(int r, int c) { const int st = (r >> 4) * 2 + (c >> 5), rr = r & 15, cc = c & 31, ob = rr * 64 + cc * 2; return st * 1024 + (ob ^ (((ob >> 9) & 1) << 5)); }
__host__ __device__ __forceinline__ void stage_rc(int b, int& R, int& C) { const int st = b / 1024, sb = b % 1024, swz = sb ^ (((sb >> 9) & 1) << 5); R = (st >> 1) * 16 + swz / 64; C = (st & 1) * 32 + (swz % 64) / 2; }
__host__ __device__ __forceinline__ int perm32(int rho) { const int n = rho >> 4, i = rho & 15; return 8 * (i >> 2) + 4 * n + (i & 3); }

struct Unit { int pm, pn; };
struct Gemm { const bf16_t* A; const bf16_t* Bt; int M, N, K; };

struct StaticOrder {
    int nM, nN, nwg, G, c;
    __host__ __device__ void init(int M, int N, int G_, int c_) { nM = M / BM; nN = N / BM; nwg = nM * nN; G = G_; c = c_; }
    __host__ __device__ bool next(int i, Unit& u) const {
        const long L = (long)i * G + c; if (L >= nwg) return false;
        int wgid = (int)L; { const int q = nwg / NXCD, r = nwg % NXCD, xcd = wgid % NXCD, off = wgid / NXCD; wgid = (xcd < r ? xcd * (q + 1) : r * (q + 1) + (xcd - r) * q) + off; }
        const int nig = WGM * nN, gid = wgid / nig, fm = gid * WGM, gsz = (nM - fm) < WGM ? (nM - fm) : WGM;
        u.pm = fm + ((wgid % nig) % gsz); u.pn = (wgid % nig) / gsz; return true;
    }
    __device__ __forceinline__ void a_ready(const Unit&) const {}
    __device__ __forceinline__ void done(const Unit&) const {}
};

__device__ __forceinline__ unsigned cvt_pk_bf16(float lo, float hi) { unsigned r; asm volatile("v_cvt_pk_bf16_f32 %0, %1, %2" : "=v"(r) : "v"(lo), "v"(hi)); return r; }
typedef unsigned u32x2 __attribute__((ext_vector_type(2)));
__device__ __forceinline__ float fast_sigmoid(float x) { return __builtin_amdgcn_rcpf(1.0f + __builtin_amdgcn_exp2f(-1.4426950408889634f * x)); }
__device__ __forceinline__ float silu_f(float x) { return x * fast_sigmoid(x); }
__device__ __forceinline__ float gelu_tanh_f(float x) { const float t = x * (1.0f + 0.044715f * x * x); return x * fast_sigmoid(1.5957691216057308f * t); }

struct EpiSwiGLU {
    static constexpr bool PERM = true, AFTER_DRAIN = false;
    bf16_t* H; int ldh;
    __device__ __forceinline__ void operator()(const f32x4 (&acc)[2][2][4][2], const Unit& u, int wr, int wc, int fr, int fq) const {
        const int row0 = u.pm * BM + wr * 64 + fr, col0 = u.pn * HALF + wc * 32 + 8 * fq;
#pragma unroll
        for (int ai = 0; ai < 2; ++ai)
#pragma unroll
            for (int m = 0; m < 4; ++m) { bf16_t* rowp = H + (size_t)(row0 + ai * HALF + m * 16) * ldh + col0;
                float h[8];
#pragma unroll
                for (int n = 0; n < 2; ++n)
#pragma unroll
                    for (int j = 0; j < 4; ++j) h[4 * n + j] = silu_f(acc[ai][0][m][n][j]) * acc[ai][1][m][n][j];
                u32x4 w; w.x = cvt_pk_bf16(h[0], h[1]); w.y = cvt_pk_bf16(h[2], h[3]); w.z = cvt_pk_bf16(h[4], h[5]); w.w = cvt_pk_bf16(h[6], h[7]);
                *(u32x4*)rowp = w; }
    }
};
struct EpiResid {
    static constexpr bool PERM = false, AFTER_DRAIN = false;
    const float* X; float* Y; float alpha, scale;
    __device__ __forceinline__ void operator()(const f32x4 (&acc)[2][2][4][2], const Unit& u, int wr, int wc, int fr, int fq) const {
        const int row0 = u.pm * BM + wr * 64 + fr, col0 = u.pn * BM + wc * 32 + 4 * fq;
#pragma unroll
        for (int ai = 0; ai < 2; ++ai)
#pragma unroll
            for (int m = 0; m < 4; ++m) { const size_t off = (size_t)(row0 + ai * HALF + m * 16) * 1024 + col0;
#pragma unroll
                for (int bj = 0; bj < 2; ++bj)
#pragma unroll
                    for (int n = 0; n < 2; ++n) { const f32x4 x = *(const f32x4*)(X + off + bj * HALF + n * 16);
                        *(f32x4*)(Y + off + bj * HALF + n * 16) = x * alpha + acc[ai][bj][m][n] * scale; }
                asm volatile("" ::: "memory"); }
    }
};
struct EpiAB {
    static constexpr bool PERM = true, AFTER_DRAIN = false;
    bf16_t* O; const float* rot;
    __device__ __forceinline__ void operator()(const f32x4 (&acc)[2][2][4][2], const Unit& u, int wr, int wc, int fr, int fq) const {
        const int row0 = u.pm * BM + wr * 64 + fr, col0 = u.pn * BM + wc * 32 + 8 * fq;
        const bool rot_lane = ((wc & 1) == 0) && (fq < 2);
#pragma unroll
        for (int bj = 0; bj < 2; ++bj) {
            const int kind = (u.pn < 2 || (u.pn == 2 && bj == 0)) ? 0 : (u.pn == 2 ? 1 : 2);
#pragma unroll
            for (int ai = 0; ai < 2; ++ai)
#pragma unroll
                for (int m = 0; m < 4; ++m) { const int row = row0 + ai * HALF + m * 16;
                    float v[8];
#pragma unroll
                    for (int n = 0; n < 2; ++n)
#pragma unroll
                        for (int j = 0; j < 4; ++j) v[4 * n + j] = acc[ai][bj][m][n][j];
                    if (kind == 0) {
                        const f32x4 c0 = *(const f32x4*)(rot + (size_t)row * 16), c1 = *(const f32x4*)(rot + (size_t)row * 16 + 4),
                                    s0 = *(const f32x4*)(rot + (size_t)row * 16 + 8), s1 = *(const f32x4*)(rot + (size_t)row * 16 + 12);
                        const float cs[8] = {c0[0], c0[1], c0[2], c0[3], c1[0], c1[1], c1[2], c1[3]}, sn[8] = {s0[0], s0[1], s0[2], s0[3], s1[0], s1[1], s1[2], s1[3]};
#pragma unroll
                        for (int e = 0; e < 8; ++e) { const float other = __shfl_xor(v[e], 16);
                            const float r = (fq == 0) ? (v[e] * cs[e] - other * sn[e]) : (v[e] * cs[e] + other * sn[e]);
                            v[e] = rot_lane ? r : v[e]; }
                    } else if (kind == 2) {
#pragma unroll
                        for (int e = 0; e < 8; ++e) v[e] = gelu_tanh_f(v[e]);
                    }
                    u32x4 w; w.x = cvt_pk_bf16(v[0], v[1]); w.y = cvt_pk_bf16(v[2], v[3]); w.z = cvt_pk_bf16(v[4], v[5]); w.w = cvt_pk_bf16(v[6], v[7]);
                    *(u32x4*)(O + (size_t)row * 1792 + col0 + bj * HALF) = w; }
        }
    }
};
struct EpiSC {
    static constexpr bool PERM = true, AFTER_DRAIN = false;
    bf16_t* Bo; bf16_t* CZ;
    __device__ __forceinline__ void operator()(const f32x4 (&acc)[2][2][4][2], const Unit& u, int wr, int wc, int fr, int fq) const {
        const int row0 = u.pm * BM + wr * 64 + fr;
        if (u.pn < 4) {
            const int col0 = u.pn * BM + wc * 32 + 8 * fq;
#pragma unroll
            for (int ai = 0; ai < 2; ++ai)
#pragma unroll
                for (int m = 0; m < 4; ++m) { bf16_t* rowp = Bo + (size_t)(row0 + ai * HALF + m * 16) * 1024 + col0;
#pragma unroll
                    for (int bj = 0; bj < 2; ++bj) { const f32x4 v0 = acc[ai][bj][m][0], v1 = acc[ai][bj][m][1];
                        u32x4 w; w.x = cvt_pk_bf16(v0[0], v0[1]); w.y = cvt_pk_bf16(v0[2], v0[3]); w.z = cvt_pk_bf16(v1[0], v1[1]); w.w = cvt_pk_bf16(v1[2], v1[3]);
                        *(u32x4*)(rowp + bj * HALF) = w; } }
        } else {
            const int col0 = (u.pn - 4) * HALF + wc * 32 + 8 * fq;
#pragma unroll
            for (int ai = 0; ai < 2; ++ai)
#pragma unroll
                for (int m = 0; m < 4; ++m) { bf16_t* rowp = CZ + (size_t)(row0 + ai * HALF + m * 16) * 1024 + col0;
                    const f32x4 v0 = acc[ai][0][m][0] * acc[ai][1][m][0], v1 = acc[ai][0][m][1] * acc[ai][1][m][1];
                    u32x4 w; w.x = cvt_pk_bf16(v0[0], v0[1]); w.y = cvt_pk_bf16(v0[2], v0[3]); w.z = cvt_pk_bf16(v1[0], v1[1]); w.w = cvt_pk_bf16(v1[2], v1[3]);
                    *(u32x4*)rowp = w; }
        }
    }
};
struct EpiStoreF32 {
    static constexpr bool PERM = false, AFTER_DRAIN = false;
    float* G;
    __device__ __forceinline__ void operator()(const f32x4 (&acc)[2][2][4][2], const Unit& u, int wr, int wc, int fr, int fq) const {
        const int row0 = u.pm * BM + wr * 64 + fr, col0 = u.pn * BM + wc * 32 + 4 * fq;
#pragma unroll
        for (int ai = 0; ai < 2; ++ai)
#pragma unroll
            for (int m = 0; m < 4; ++m) { const size_t off = (size_t)(row0 + ai * HALF + m * 16) * 1024 + col0;
#pragma unroll
                for (int bj = 0; bj < 2; ++bj)
#pragma unroll
                    for (int n = 0; n < 2; ++n) *(f32x4*)(G + off + bj * HALF + n * 16) = acc[ai][bj][m][n]; }
    }
};
struct EpiPLE {
    static constexpr bool PERM = false, AFTER_DRAIN = false;
    const float* X; const float* G; float* Y; bf16_t* XB;
    __device__ __forceinline__ void operator()(const f32x4 (&acc)[2][2][4][2], const Unit& u, int wr, int wc, int fr, int fq) const {
        const int row0 = u.pm * BM + wr * 64 + fr, col0 = u.pn * BM + wc * 32 + 4 * fq;
        unsigned eo = (unsigned)row0 * 1024u + (unsigned)col0;
#pragma unroll
        for (int ai = 0; ai < 2; ++ai)
#pragma unroll
            for (int m = 0; m < 4; ++m) { const unsigned off = eo + (unsigned)((ai * HALF + m * 16) * 1024);
#pragma unroll
                for (int bj = 0; bj < 2; ++bj) {
#pragma unroll
                    for (int n = 0; n < 2; ++n) { const unsigned o = off + bj * HALF + n * 16;
                        const f32x4 x = *(const f32x4*)((const char*)X + (size_t)(o * 4u)), g = *(const f32x4*)((const char*)G + (size_t)(o * 4u)); const f32x4 a = acc[ai][bj][m][n]; f32x4 r;
#pragma unroll
                        for (int j = 0; j < 4; ++j) r[j] = x[j] + g[j] * fast_sigmoid(a[j]);
                        *(f32x4*)((char*)Y + (size_t)(o * 4u)) = r; u32x2 w; w.x = cvt_pk_bf16(r[0], r[1]); w.y = cvt_pk_bf16(r[2], r[3]); *(u32x2*)((char*)XB + (size_t)(o * 2u)) = w;
                        asm volatile("" ::: "memory"); } } }
    }
};
template <class Epi, class Sched, bool ALIGN_EPI = false, bool SP2 = false>
__device__ __forceinline__ void gemm_phase(PG8_LAS unsigned char* lds, const Gemm g, const Sched& S, const Epi& E) {
    int tid_op = threadIdx.x; asm volatile("" : "+v"(tid_op));
    const int tid = tid_op, wid = __builtin_amdgcn_readfirstlane(tid >> 6), lane = tid & 63, wr = wid >> 2, wc = wid & 3, fr = lane & 15, fq = lane >> 4;
    int K_op = g.K; asm volatile("" : "+s"(K_op)); const int K = K_op, nt = K / BK;
    unsigned voffA[2], voffB[2];
#pragma unroll
    for (int i = 0; i < 2; ++i) { int R, C; stage_rc(tid * 16 + i * 8192, R, C); const int Rb = Epi::PERM ? ((R & ~31) + perm32(R & 31)) : R;
        voffA[i] = (unsigned)(R * K + C) * 2u; voffB[i] = (unsigned)(Rb * K + C) * 2u; }
    const size_t kstep = (size_t)(BK * 2);
    const size_t hstep = (size_t)HALF * K * 2;
    const size_t tstep = 2 * hstep;
    const unsigned ldsw = (unsigned)wid * 1024u;
    const int aoff = lds_byte(wr * 64 + fr, fq * 8), boff = lds_byte(wc * 32 + fr, fq * 8);
#define PG8_SA(b, h) (((b) * 2 + (h)) * HTB)
#define PG8_SB(b, h) ((4 + (b) * 2 + (h)) * HTB)
#define PG8_STAGE(bufoff, gbase, voff) do { _Pragma("unroll") for (int _i = 0; _i < 2; ++_i) \
        __builtin_amdgcn_global_load_lds((const unsigned*)((const char*)(gbase) + (voff)[_i]), (PG8_LAS unsigned*)(lds + (bufoff) + ldsw + _i * 8192), 16, 0, 0); } while (0)
#define PG8_LDA(dst, b, h) do { _Pragma("unroll") for (int m = 0; m < 4; ++m) _Pragma("unroll") for (int k = 0; k < 2; ++k) dst[m][k] = *(const PG8_LAS bf16x8*)(lds + PG8_SA(b, h) + aoff + m * 2048 + k * 1024); } while (0)
#define PG8_LDB(dst, b, h) do { _Pragma("unroll") for (int n = 0; n < 2; ++n) _Pragma("unroll") for (int k = 0; k < 2; ++k) dst[n][k] = *(const PG8_LAS bf16x8*)(lds + PG8_SB(b, h) + boff + n * 2048 + k * 1024); } while (0)
#define PG8_MMA(ai, bj, At, Bt) do { __builtin_amdgcn_s_setprio(1); _Pragma("unroll") for (int m = 0; m < 4; ++m) _Pragma("unroll") for (int n = 0; n < 2; ++n) _Pragma("unroll") for (int k = 0; k < 2; ++k) \
        acc[ai][bj][m][n] = __builtin_amdgcn_mfma_f32_16x16x32_bf16(Bt[n][k], At[m][k], acc[ai][bj][m][n], 0, 0, 0); __builtin_amdgcn_s_setprio(0); } while (0)
#define PG8_WAIT_V(n) asm volatile("s_waitcnt vmcnt(" #n ")" ::: "memory")
#define PG8_WAIT_L(n) asm volatile("s_waitcnt lgkmcnt(" #n ")" ::: "memory")
#define PG8_BAR __builtin_amdgcn_s_barrier()
#define PG8_SCHED __builtin_amdgcn_sched_barrier(0)
    Unit cur, nxt; int ui = 0;
    if (!S.next(0, cur)) return;
    f32x4 acc[2][2][4][2];
#pragma unroll
    for (int a = 0; a < 2; ++a)
#pragma unroll
        for (int b = 0; b < 2; ++b)
#pragma unroll
            for (int m = 0; m < 4; ++m)
#pragma unroll
                for (int n = 0; n < 2; ++n) acc[a][b][m][n] = (f32x4){0.f, 0.f, 0.f, 0.f};
    bf16x8 At[4][2], B0[2][2], B1[2][2];
    const char* cA = (const char*)g.A + (size_t)cur.pm * tstep; const char* cB = (const char*)g.Bt + (size_t)cur.pn * tstep;
    S.a_ready(cur);
    if constexpr (SP2) {
        PG8_STAGE(PG8_SB(0, 0), cB, voffB); PG8_STAGE(PG8_SB(0, 1), cB + hstep, voffB); PG8_STAGE(PG8_SA(0, 0), cA, voffA); PG8_STAGE(PG8_SA(0, 1), cA + hstep, voffA);
        if (wr == 1) PG8_BAR;
        PG8_WAIT_V(2); PG8_BAR;
        PG8_STAGE(PG8_SB(1, 0), cB + kstep, voffB); PG8_STAGE(PG8_SA(1, 0), cA + kstep, voffA); PG8_STAGE(PG8_SB(1, 1), cB + hstep + kstep, voffB);
        PG8_WAIT_V(6); PG8_BAR;
    } else {
        PG8_STAGE(PG8_SB(0, 0), cB, voffB); PG8_STAGE(PG8_SA(0, 0), cA, voffA); PG8_STAGE(PG8_SB(0, 1), cB + hstep, voffB); PG8_STAGE(PG8_SA(0, 1), cA + hstep, voffA);
        if (wr == 1) PG8_BAR;
        PG8_WAIT_V(4); PG8_BAR;
        PG8_STAGE(PG8_SB(1, 0), cB + kstep, voffB); PG8_STAGE(PG8_SA(1, 0), cA + kstep, voffA); PG8_STAGE(PG8_SB(1, 1), cB + hstep + kstep, voffB);
        PG8_WAIT_V(6); PG8_BAR;
    }
    for (;;) {
        const bool has_next = S.next(ui + 1, nxt);
        const char* nA = has_next ? (const char*)g.A + (size_t)nxt.pm * tstep : cA; const char* nB = has_next ? (const char*)g.Bt + (size_t)nxt.pn * tstep : cB;
        for (int t = 0; t < nt; t += 2) {
            const bool last = (t == nt - 2);
            const char* a1 = cA + (size_t)(t + 1) * kstep;
            const char* a2 = last ? nA : cA + (size_t)(t + 2) * kstep; const char* b2 = last ? nB : cB + (size_t)(t + 2) * kstep;
            const char* a3 = a2 + kstep; const char* b3 = b2 + kstep;
            if (last && has_next) S.a_ready(nxt);
            if constexpr (SP2) {
            PG8_LDB(B0, 0, 0); PG8_LDB(B1, 0, 1); PG8_SCHED; PG8_LDA(At, 0, 0); PG8_STAGE(PG8_SA(1, 1), a1 + hstep, voffA);
            PG8_WAIT_V(8); PG8_WAIT_L(0); PG8_BAR; PG8_MMA(0, 0, At, B0); PG8_MMA(0, 1, At, B1); PG8_BAR; PG8_SCHED;
            PG8_LDA(At, 0, 1); PG8_STAGE(PG8_SB(0, 0), b2, voffB); PG8_STAGE(PG8_SB(0, 1), b2 + hstep, voffB); PG8_STAGE(PG8_SA(0, 0), a2, voffA);
            PG8_WAIT_V(8); PG8_WAIT_L(0); PG8_BAR; PG8_MMA(1, 0, At, B0); PG8_MMA(1, 1, At, B1); PG8_BAR; PG8_SCHED;
            PG8_LDB(B0, 1, 0); PG8_LDB(B1, 1, 1); PG8_SCHED; PG8_LDA(At, 1, 0); PG8_STAGE(PG8_SA(0, 1), a2 + hstep, voffA);
            PG8_WAIT_V(8); PG8_WAIT_L(0); PG8_BAR; PG8_MMA(0, 0, At, B0); PG8_MMA(0, 1, At, B1); PG8_BAR; PG8_SCHED;
            PG8_LDA(At, 1, 1); PG8_STAGE(PG8_SB(1, 0), b3, voffB); PG8_STAGE(PG8_SB(1, 1), b3 + hstep, voffB); PG8_STAGE(PG8_SA(1, 0), a3, voffA);
            PG8_WAIT_V(8); PG8_WAIT_L(0); PG8_BAR; PG8_MMA(1, 0, At, B0); PG8_MMA(1, 1, At, B1); PG8_BAR; PG8_SCHED;
            } else {
            PG8_LDB(B0, 0, 0); PG8_SCHED; PG8_LDA(At, 0, 0); PG8_STAGE(PG8_SA(1, 1), a1 + hstep, voffA);
            PG8_WAIT_L(8); PG8_BAR; PG8_WAIT_L(0); PG8_MMA(0, 0, At, B0); PG8_BAR; PG8_SCHED;
            PG8_LDB(B1, 0, 1); PG8_STAGE(PG8_SB(0, 0), b2, voffB);
            PG8_BAR; PG8_WAIT_L(0); PG8_MMA(0, 1, At, B1); PG8_BAR;
            PG8_LDA(At, 0, 1); PG8_STAGE(PG8_SA(0, 0), a2, voffA);
            PG8_BAR; PG8_WAIT_L(0); PG8_MMA(1, 0, At, B0); PG8_BAR; PG8_SCHED;
            PG8_STAGE(PG8_SB(0, 1), b2 + hstep, voffB);
            PG8_WAIT_V(6); PG8_BAR; PG8_MMA(1, 1, At, B1); PG8_BAR;
            PG8_LDB(B0, 1, 0); PG8_SCHED; PG8_LDA(At, 1, 0); PG8_STAGE(PG8_SA(0, 1), a2 + hstep, voffA);
            PG8_WAIT_L(8); PG8_BAR; PG8_WAIT_L(0); PG8_MMA(0, 0, At, B0); PG8_BAR; PG8_SCHED;
            PG8_LDB(B1, 1, 1); PG8_STAGE(PG8_SB(1, 0), b3, voffB);
            PG8_BAR; PG8_WAIT_L(0); PG8_MMA(0, 1, At, B1); PG8_BAR;
            PG8_LDA(At, 1, 1); PG8_STAGE(PG8_SA(1, 0), a3, voffA);
            PG8_BAR; PG8_WAIT_L(0); PG8_MMA(1, 0, At, B0); PG8_BAR; PG8_SCHED;
            PG8_STAGE(PG8_SB(1, 1), b3 + hstep, voffB);
            PG8_WAIT_V(6); PG8_BAR; PG8_MMA(1, 1, At, B1); PG8_BAR;
            }
        }
        if constexpr (ALIGN_EPI) { if (wr == 0) PG8_BAR; }
        if constexpr (!Epi::AFTER_DRAIN) { E(acc, cur, wr, wc, fr, fq); S.done(cur); }
        if (!has_next) break;
#pragma unroll
        for (int a = 0; a < 2; ++a)
#pragma unroll
            for (int b = 0; b < 2; ++b)
#pragma unroll
                for (int m = 0; m < 4; ++m)
#pragma unroll
                    for (int n = 0; n < 2; ++n) acc[a][b][m][n] = (f32x4){0.f, 0.f, 0.f, 0.f};
        cur = nxt; cA = nA; cB = nB; ++ui;
        if constexpr (ALIGN_EPI) { if (wr == 1) PG8_BAR; }
    }
    PG8_WAIT_V(0);
    if constexpr (!ALIGN_EPI) { if (wr == 0) PG8_BAR; }
    PG8_BAR;
    if constexpr (Epi::AFTER_DRAIN) { E.fused(acc, cur, wr, wc, fr, fq, lds, wid, lane); S.done(cur); }
#undef PG8_SA
#undef PG8_SB
#undef PG8_STAGE
#undef PG8_LDA
#undef PG8_LDB
#undef PG8_MMA
#undef PG8_WAIT_V
#undef PG8_WAIT_L
#undef PG8_BAR
#undef PG8_SCHED
}
}
#define PRO_SECT 15
#define PRO_SUB 0

#define LAS __attribute__((address_space(3)))
typedef unsigned short bf16;
typedef unsigned u32x4 __attribute__((ext_vector_type(4)));
typedef unsigned u32x2 __attribute__((ext_vector_type(2)));
typedef float f32x4 __attribute__((ext_vector_type(4)));
typedef short bf16x8 __attribute__((ext_vector_type(8)));
typedef short s16x4 __attribute__((ext_vector_type(4)));

constexpr int S = 16384, D = 1024, FF = 2816, NW = 8;
constexpr float LN_EPS = 1e-5f;
constexpr float ALPHA = 1.4142135623730951f;
constexpr size_t MiB = 1u << 20;
constexpr size_t WS_CTL = 0, WS_ROT = 1 * MiB, WS_SGUW = 2 * MiB, WS_W = 4 * MiB;
constexpr size_t W_FFN_STRIDE = 16 * MiB + MiB / 2, W_FFN_DOWN = 11 * MiB;
constexpr size_t WS_ABIN = WS_W + 66 * MiB, WS_ABOUT = WS_ABIN + 3 * MiB + MiB / 2, WS_SCIN = WS_ABOUT + 2 * MiB, WS_SCOUT = WS_SCIN + 6 * MiB,
                 WS_PLEP = WS_SCOUT + 2 * MiB, WS_PLEG = WS_PLEP + 1 * MiB, WS_WEND = WS_PLEG + 4 * MiB;
constexpr size_t WS_XB = 90 * MiB, WS_MIX = 122 * MiB, WS_BIG = 154 * MiB, WS_END = 250 * MiB;
static_assert(WS_WEND <= WS_XB, "ws map");
constexpr int LDS_BYTES = 133120;
constexpr int NPHASE = 23;

enum { I_X = 0, I_P, I_POS, I_LNG, I_LNB, I_FWG, I_FWU, I_FWD, I_ABIN, I_SINK, I_SLNG, I_SLNB, I_SWS, I_SBS, I_ABOUT, I_SCIN, I_SCCW, I_SCOUT, I_PLEP, I_PLEG, I_OUT, I_WS, I_N };
struct Params { const void* ptr[I_N]; int ph_lo, ph_hi; };
template <class T> __device__ __forceinline__ T* ldp(const Params& P, int i) { asm volatile("" : "+s"(i)); return (T*)P.ptr[i]; }

__device__ __forceinline__ unsigned f2bf(float f) { unsigned u = __builtin_bit_cast(unsigned, f); return (u + 0x7fffu + ((u >> 16) & 1u)) >> 16; }
__device__ __forceinline__ unsigned pk2(float lo, float hi) { return f2bf(lo) | (f2bf(hi) << 16); }
__device__ __forceinline__ float bf_lo(unsigned w) { return __builtin_bit_cast(float, w << 16); }
__device__ __forceinline__ float bf_hi(unsigned w) { return __builtin_bit_cast(float, w & 0xffff0000u); }
__device__ __forceinline__ float wave_sum(float v) {
#pragma unroll
    for (int o = 1; o < 64; o <<= 1) v += __shfl_xor(v, o);
    return v;
}
#define LDS_WAIT() asm volatile("s_waitcnt lgkmcnt(0)" ::: "memory")

__device__ __forceinline__ void transpose_item(const float* W, int K, int N, bf16* WT, int k0, int n0, int drow0, LAS float* scr, int lane) {
#pragma unroll 8
    for (int i = 0; i < 32; ++i) { const int kk = 2 * i + (lane >> 5); scr[kk * 33 + (lane & 31)] = W[(size_t)(k0 + kk) * N + n0 + (lane & 31)]; }
    LDS_WAIT(); asm volatile("" ::: "memory");
    const int c = lane & 7;
#pragma unroll
    for (int j = 0; j < 4; ++j) { const int n = (lane >> 3) + 8 * j; const LAS float* s = scr + (8 * c) * 33 + n;
        u32x4 o; o.x = pk2(s[0 * 33], s[1 * 33]); o.y = pk2(s[2 * 33], s[3 * 33]); o.z = pk2(s[4 * 33], s[5 * 33]); o.w = pk2(s[6 * 33], s[7 * 33]);
        *(u32x4*)(WT + (size_t)(drow0 + n) * K + k0 + 8 * c) = o; }
    LDS_WAIT(); asm volatile("" ::: "memory");
}
__device__ __forceinline__ int map_gu(int n0, int up) { return (n0 >> 7) * 256 + up * 128 + (n0 & 127); }

__device__ __forceinline__ void prologue(const Params& P, LAS unsigned char* lds, int tid, int wave, int lane) {
    unsigned char* ws = ldp<unsigned char>(P, I_WS);
    LAS float* scr = (LAS float*)(lds + wave * 16384);
    const int G = gridDim.x, gw = blockIdx.x * NW + wave, NGW = G * NW;
    constexpr int C_FFN = 1408, N_FFN = 12 * C_FFN, C_ABIN = 16 * 56, C_SQ = 512, C_SCIN = 16 * 96, C_PLEP = 4 * 32;
    constexpr int NITEMS = N_FFN + C_ABIN + C_SQ + C_SCIN + C_SQ + 2 * C_PLEP + 2 * C_SQ;
#ifndef PRO_SECT
#define PRO_SECT 15
#endif
    if (PRO_SECT & 1) for (int it = gw; it < NITEMS; it += NGW) {
        int r = it;
        if ((PRO_SUB == 1 && r >= N_FFN) || (PRO_SUB == 2 && r < N_FFN)) continue;
        if (r < N_FFN) { const int mat = r / C_FFN, item = r % C_FFN, lh = mat / 3, which = mat % 3;
            bf16* base = (bf16*)(ws + WS_W + (size_t)lh * W_FFN_STRIDE);
            if (which < 2) { const float* W = (which == 0 ? ldp<const float>(P, I_FWG) : ldp<const float>(P, I_FWU)) + (size_t)lh * D * FF; const int kb = item / 88, nb = item % 88;
                transpose_item(W, D, FF, base, 64 * kb, 32 * nb, map_gu(32 * nb, which), scr, lane); }
            else { const float* W = ldp<const float>(P, I_FWD) + (size_t)lh * FF * D; const int kb = item / 32, nb = item % 32;
                transpose_item(W, FF, D, (bf16*)((unsigned char*)base + W_FFN_DOWN), 64 * kb, 32 * nb, 32 * nb, scr, lane); }
            continue; }
        r -= N_FFN;
        if (r < C_ABIN) { const int kb = r / 56, nb = r % 56; transpose_item(ldp<const float>(P, I_ABIN), D, 1792, (bf16*)(ws + WS_ABIN), 64 * kb, 32 * nb, 32 * nb, scr, lane); continue; } r -= C_ABIN;
        if (r < C_SQ) { const int kb = r / 32, nb = r % 32; transpose_item(ldp<const float>(P, I_ABOUT), D, D, (bf16*)(ws + WS_ABOUT), 64 * kb, 32 * nb, 32 * nb, scr, lane); continue; } r -= C_SQ;
        if (r < C_SCIN) { const int kb = r / 96, nb = r % 96, n0 = 32 * nb;
            const int dr = n0 < 1024 ? n0 : (n0 < 2048 ? 1024 + map_gu(n0 - 1024, 0) : 1024 + map_gu(n0 - 2048, 1));
            transpose_item(ldp<const float>(P, I_SCIN), D, 3072, (bf16*)(ws + WS_SCIN), 64 * kb, n0, dr, scr, lane); continue; } r -= C_SCIN;
        if (r < C_SQ) { const int kb = r / 32, nb = r % 32; transpose_item(ldp<const float>(P, I_SCOUT), D, D, (bf16*)(ws + WS_SCOUT), 64 * kb, 32 * nb, 32 * nb, scr, lane); continue; } r -= C_SQ;
        if (r < 2 * C_PLEP) { const int l = r / C_PLEP, q = r % C_PLEP, kb = q / 32, nb = q % 32;
            transpose_item(ldp<const float>(P, I_PLEP) + (size_t)l * 256 * D, 256, D, (bf16*)(ws + WS_PLEP) + (size_t)l * D * 256, 64 * kb, 32 * nb, 32 * nb, scr, lane); continue; } r -= 2 * C_PLEP;
        { const int l = r / C_SQ, q = r % C_SQ, kb = q / 32, nb = q % 32;
            transpose_item(ldp<const float>(P, I_PLEG) + (size_t)l * D * D, D, D, (bf16*)(ws + WS_PLEG) + (size_t)l * D * D, 64 * kb, 32 * nb, 32 * nb, scr, lane); }
    }
    const int gt = blockIdx.x * (NW * 64) + tid, NGT = G * NW * 64;
    if (PRO_SECT & 2) { const float* x = ldp<const float>(P, I_X); bf16* XB = (bf16*)(ws + WS_XB);
      for (int c = gt; c < S * D / 8; c += NGT) { const f32x4 a = *(const f32x4*)(x + (size_t)c * 8), b = *(const f32x4*)(x + (size_t)c * 8 + 4);
          u32x4 o; o.x = pk2(a[0], a[1]); o.y = pk2(a[2], a[3]); o.z = pk2(b[0], b[1]); o.w = pk2(b[2], b[3]); *(u32x4*)(XB + (size_t)c * 8) = o; } }
    if (PRO_SECT & 4) { bf16* Wt = (bf16*)(ws + WS_SGUW);
      for (int c = gt; c < 8 * 128 * 128; c += NGT) { const int s = c & 127, t = (c >> 7) & 127; Wt[c] = (bf16)(s <= t ? f2bf(ldp<const float>(P, I_SWS)[c]) : 0u); } }
    if (PRO_SECT & 8) { float* rot = (float*)(ws + WS_ROT);
      for (int c = gt; c < S * 8; c += NGT) { const int tok = c >> 3, i = c & 7;
          const float inv = i == 0 ? 1.0f : i == 1 ? 0.19392274f : i == 2 ? 0.03760603f : i == 3 ? 0.0072926646f : i == 4 ? 0.0014142136f : i == 5 ? 0.0002742482f : i == 6 ? 5.3182957e-05f : 1.0313385e-05f;
          const float angf = (float)ldp<const int>(P, I_POS)[tok] * inv; const double a = (double)angf;
          const double kq = __builtin_rint(a * 0.63661977236758134308); const double rr = (a - kq * 1.5707963267948966192) - kq * 6.123233995736766e-17; const int q = ((int)kq) & 3;
          const double r2 = rr * rr;
          const double sn = rr * (1.0 + r2 * (-1.0 / 6 + r2 * (1.0 / 120 + r2 * (-1.0 / 5040 + r2 * (1.0 / 362880 + r2 * (-1.0 / 39916800 + r2 * (1.0 / 6227020800.0)))))));
          const double cs = 1.0 + r2 * (-0.5 + r2 * (1.0 / 24 + r2 * (-1.0 / 720 + r2 * (1.0 / 40320 + r2 * (-1.0 / 3628800 + r2 * (1.0 / 479001600.0))))));
          const double co = (q == 0) ? cs : (q == 1) ? -sn : (q == 2) ? -cs : sn;
          const double si = (q == 0) ? sn : (q == 1) ? cs : (q == 2) ? -sn : -cs;
          rot[(size_t)tok * 16 + i] = (float)co; rot[(size_t)tok * 16 + 8 + i] = (float)si; } }
}

__device__ __forceinline__ void ln_phase(float* Y, const float* g, const float* b, bf16* XB, int wave, int lane) {
    const int gw = blockIdx.x * NW + wave, NGW = gridDim.x * NW;
    f32x4 gv[4], bv[4];
#pragma unroll
    for (int j = 0; j < 4; ++j) { gv[j] = *(const f32x4*)(g + lane * 4 + 256 * j); bv[j] = *(const f32x4*)(b + lane * 4 + 256 * j); }
    for (int m = gw; m < S; m += NGW) {
        float* yr = Y + (size_t)m * D + lane * 4; f32x4 v[4]; float s = 0.f;
#pragma unroll
        for (int j = 0; j < 4; ++j) { v[j] = *(const f32x4*)(yr + 256 * j); s += (v[j][0] + v[j][1]) + (v[j][2] + v[j][3]); }
        const float mean = wave_sum(s) * (1.f / D); float s2 = 0.f;
#pragma unroll
        for (int j = 0; j < 4; ++j) { v[j] = v[j] - mean; s2 += (v[j][0] * v[j][0] + v[j][1] * v[j][1]) + (v[j][2] * v[j][2] + v[j][3] * v[j][3]); }
        const float rstd = 1.f / sqrtf(wave_sum(s2) * (1.f / D) + LN_EPS);
        bf16* xr = XB + (size_t)m * D + lane * 4;
#pragma unroll
        for (int j = 0; j < 4; ++j) { const f32x4 o = v[j] * rstd * gv[j] + bv[j]; *(f32x4*)(yr + 256 * j) = o;
            u32x2 w; w.x = pk2(o[0], o[1]); w.y = pk2(o[2], o[3]); *(u32x2*)(xr + 256 * j) = w; }
    }
}

__device__ __forceinline__ void attn_unit(LAS unsigned char* lds, const bf16* QKV, const float* sinks, bf16* MIX, int blk, int kvh, int tid, int wid, int lane) {
    LAS bf16* Ks = (LAS bf16*)lds;
    LAS bf16* Vt = (LAS bf16*)(lds + 36864);
    const int tok0 = blk * 128 - 128;
#pragma unroll
    for (int i = 0; i < 4; ++i) { const int c = tid + 512 * i, row = c & 255, cc = c >> 8, tok = tok0 + row;
        u32x4 kv = (u32x4){0u, 0u, 0u, 0u}, vv = (u32x4){0u, 0u, 0u, 0u};
        if (tok >= 0) { kv = *(const u32x4*)(QKV + (size_t)tok * 1792 + 512 + kvh * 64 + cc * 8); vv = *(const u32x4*)(QKV + (size_t)tok * 1792 + 640 + kvh * 64 + cc * 8); }
        *(LAS u32x4*)(Ks + row * 72 + cc * 8) = kv;
        LAS bf16* vp = Vt + (cc * 8) * 264 + row;
        vp[0 * 264] = (bf16)(vv.x & 0xffffu); vp[1 * 264] = (bf16)(vv.x >> 16); vp[2 * 264] = (bf16)(vv.y & 0xffffu); vp[3 * 264] = (bf16)(vv.y >> 16);
        vp[4 * 264] = (bf16)(vv.z & 0xffffu); vp[5 * 264] = (bf16)(vv.z >> 16); vp[6 * 264] = (bf16)(vv.w & 0xffffu); vp[7 * 264] = (bf16)(vv.w >> 16); }
    __syncthreads();
    const int g = wid >> 1, qh = kvh * 4 + g, qbase = (wid & 1) * 64, l15 = lane & 15, l4 = lane >> 4;
    const float sink2 = sinks[qh] * 1.4426950408889634f;
    const float SC = 0.125f * 1.4426950408889634f;
#pragma unroll 1
    for (int i = 0; i < 4; ++i) {
        const int q0 = qbase + 16 * i, qi = q0 + l15; const size_t qtok = (size_t)blk * 128 + qi;
        bf16x8 qf[2];
#pragma unroll
        for (int ks = 0; ks < 2; ++ks) qf[ks] = *(const bf16x8*)(QKV + qtok * 1792 + qh * 64 + ks * 32 + l4 * 8);
        f32x4 s[16];
#pragma unroll
        for (int kt = 0; kt < 16; ++kt) { f32x4 a = (f32x4){0.f, 0.f, 0.f, 0.f};
#pragma unroll
            for (int ks = 0; ks < 2; ++ks) { const bf16x8 kf = *(const LAS bf16x8*)(Ks + (kt * 16 + l15) * 72 + ks * 32 + l4 * 8); a = __builtin_amdgcn_mfma_f32_16x16x32_bf16(kf, qf[ks], a, 0, 0, 0); }
            s[kt] = a; if ((kt & 3) == 3) __builtin_amdgcn_sched_barrier(0); }
        float mx = sink2;
#pragma unroll
        for (int kt = 0; kt < 16; ++kt)
#pragma unroll
            for (int r = 0; r < 4; ++r) { const int kj = kt * 16 + l4 * 4 + r; const bool valid = (kj > qi) && (kj <= qi + 128) && (blk > 0 || kj >= 128);
                const float t = valid ? s[kt][r] * SC : -1e30f; s[kt][r] = t; mx = fmaxf(mx, t); }
        mx = fmaxf(mx, __shfl_xor(mx, 16)); mx = fmaxf(mx, __shfl_xor(mx, 32));
        float sum = 0.f;
#pragma unroll
        for (int kt = 0; kt < 16; ++kt)
#pragma unroll
            for (int r = 0; r < 4; ++r) { const float p = __builtin_amdgcn_exp2f(s[kt][r] - mx); s[kt][r] = p; sum += p; }
        sum += __shfl_xor(sum, 16); sum += __shfl_xor(sum, 32);
        const float inv = 1.0f / (sum + __builtin_amdgcn_exp2f(sink2 - mx));
        bf16x8 pb[8];
#pragma unroll
        for (int kg = 0; kg < 8; ++kg) { const f32x4 a = s[2 * kg], b = s[2 * kg + 1];
            u32x4 w; w.x = pk2(a[0], a[1]); w.y = pk2(a[2], a[3]); w.z = pk2(b[0], b[1]); w.w = pk2(b[2], b[3]); pb[kg] = __builtin_bit_cast(bf16x8, w); }
#pragma unroll
        for (int dt = 0; dt < 4; ++dt) { f32x4 o = (f32x4){0.f, 0.f, 0.f, 0.f};
#pragma unroll
            for (int kg = 0; kg < 8; ++kg) { const LAS bf16* vp = Vt + (dt * 16 + l15) * 264 + kg * 32 + l4 * 4;
                const u32x2 lo = *(const LAS u32x2*)vp, hi = *(const LAS u32x2*)(vp + 16);
                const u32x4 av = (u32x4){lo.x, lo.y, hi.x, hi.y};
                o = __builtin_amdgcn_mfma_f32_16x16x32_bf16(__builtin_bit_cast(bf16x8, av), pb[kg], o, 0, 0, 0); }
            __builtin_amdgcn_sched_barrier(0);
            u32x2 w; w.x = pk2(o[0] * inv, o[1] * inv); w.y = pk2(o[2] * inv, o[3] * inv);
            *(u32x2*)(MIX + qtok * 1024 + qh * 64 + dt * 16 + l4 * 4) = w; }
    }
    __syncthreads();
}

__device__ __forceinline__ void sgu_unit(LAS unsigned char* lds, const bf16* QKV, const float* lng, const float* lnb, const bf16* Wt, const float* bs, bf16* MIX,
                                         int chunk, int ghalf, int tid, int wid, int lane) {
    LAS bf16* Vt = (LAS bf16*)lds;
    LAS float* st = (LAS float*)(lds + 69632);
    const int tokb = chunk * 128;
#pragma unroll 2
    for (int i = 0; i < 16; ++i) { const int t = wid * 16 + i;
        const u32x4 raw = *(const u32x4*)(QKV + (size_t)(tokb + t) * 1792 + 1280 + lane * 8);
        float f[8] = {bf_lo(raw.x), bf_hi(raw.x), bf_lo(raw.y), bf_hi(raw.y), bf_lo(raw.z), bf_hi(raw.z), bf_lo(raw.w), bf_hi(raw.w)};
        float s = 0.f;
#pragma unroll
        for (int e = 0; e < 8; ++e) s += f[e];
        const float mean = wave_sum(s) * (1.f / 512.f); float q = 0.f;
#pragma unroll
        for (int e = 0; e < 8; ++e) { const float d = f[e] - mean; q += d * d; }
        const float rstd = 1.f / sqrtf(wave_sum(q) * (1.f / 512.f) + LN_EPS);
        if (lane == 0) { st[2 * t] = mean; st[2 * t + 1] = rstd; } }
    __syncthreads();
#pragma unroll 2
    for (int i = 0; i < 8; ++i) { const int c = tid + 512 * i, t = c & 127, fc = c >> 7, f0 = ghalf * 256 + fc * 8;
        const u32x4 raw = *(const u32x4*)(QKV + (size_t)(tokb + t) * 1792 + 1280 + f0);
        const float mean = st[2 * t], rstd = st[2 * t + 1];
        const f32x4 g0 = *(const f32x4*)(lng + f0), g1 = *(const f32x4*)(lng + f0 + 4), b0 = *(const f32x4*)(lnb + f0), b1 = *(const f32x4*)(lnb + f0 + 4);
        const float f[8] = {bf_lo(raw.x), bf_hi(raw.x), bf_lo(raw.y), bf_hi(raw.y), bf_lo(raw.z), bf_hi(raw.z), bf_lo(raw.w), bf_hi(raw.w)};
        const float gg[8] = {g0[0], g0[1], g0[2], g0[3], g1[0], g1[1], g1[2], g1[3]}, bb[8] = {b0[0], b0[1], b0[2], b0[3], b1[0], b1[1], b1[2], b1[3]};
        LAS bf16* vp = Vt + (fc * 8) * 136 + t;
#pragma unroll
        for (int e = 0; e < 8; ++e) vp[e * 136] = (bf16)f2bf((f[e] - mean) * rstd * gg[e] + bb[e]); }
    __syncthreads();
    const int gi = wid >> 1, G = ghalf * 4 + gi, th = wid & 1, l15 = lane & 15, l4 = lane >> 4;
#pragma unroll 1
    for (int tt = 0; tt < 4; ++tt) { const int t0 = th * 64 + tt * 16, nks = (t0 + 16 + 31) >> 5;
        f32x4 acc[4];
#pragma unroll
        for (int dt = 0; dt < 4; ++dt) acc[dt] = (f32x4){0.f, 0.f, 0.f, 0.f};
        for (int ks = 0; ks < nks; ++ks) { const bf16x8 b = *(const bf16x8*)(Wt + ((size_t)G * 128 + t0 + l15) * 128 + ks * 32 + l4 * 8);
#pragma unroll
            for (int dt = 0; dt < 4; ++dt) { const bf16x8 a = *(const LAS bf16x8*)(Vt + (gi * 64 + dt * 16 + l15) * 136 + ks * 32 + l4 * 8); acc[dt] = __builtin_amdgcn_mfma_f32_16x16x32_bf16(a, b, acc[dt], 0, 0, 0); } }
        const int t = t0 + l15; const float bias = bs[G * 128 + t]; const size_t tok = (size_t)tokb + t;
#pragma unroll
        for (int dt = 0; dt < 4; ++dt) { const int f = G * 64 + dt * 16 + l4 * 4;
            const u32x2 uu = *(const u32x2*)(QKV + tok * 1792 + 768 + f);
            u32x2 w; w.x = pk2(bf_lo(uu.x) * (acc[dt][0] + bias), bf_hi(uu.x) * (acc[dt][1] + bias)); w.y = pk2(bf_lo(uu.y) * (acc[dt][2] + bias), bf_hi(uu.y) * (acc[dt][3] + bias));
            *(u32x2*)(MIX + tok * 1024 + 512 + f) = w; }
    }
    __syncthreads();
}

__device__ __forceinline__ void conv_phase(const bf16* Bo, const bf16* CZ, const float* cw, bf16* MIX, int tid) {
    const int gt = blockIdx.x * (NW * 64) + tid, NGT = gridDim.x * NW * 64;
    const int cc = gt & 127;
    float w0[8], w1[8], w2[8];
#pragma unroll
    for (int e = 0; e < 8; ++e) { w0[e] = cw[cc * 8 + e]; w1[e] = cw[1024 + cc * 8 + e]; w2[e] = cw[2048 + cc * 8 + e]; }
    for (int c = gt; c < S * 128; c += NGT) { const int t = c >> 7; const size_t o = (size_t)t * 1024 + cc * 8;
        const u32x4 z0 = *(const u32x4*)(CZ + o), bb = *(const u32x4*)(Bo + o);
        const u32x4 z1 = t >= 1 ? *(const u32x4*)(CZ + o - 1024) : (u32x4){0u, 0u, 0u, 0u};
        const u32x4 z2 = t >= 2 ? *(const u32x4*)(CZ + o - 2048) : (u32x4){0u, 0u, 0u, 0u};
        const unsigned a0[4] = {z0.x, z0.y, z0.z, z0.w}, a1[4] = {z1.x, z1.y, z1.z, z1.w}, a2[4] = {z2.x, z2.y, z2.z, z2.w}, ab[4] = {bb.x, bb.y, bb.z, bb.w};
        unsigned r[4];
#pragma unroll
        for (int k = 0; k < 4; ++k) {
            const float ylo = w0[2 * k] * bf_lo(a2[k]) + w1[2 * k] * bf_lo(a1[k]) + w2[2 * k] * bf_lo(a0[k]);
            const float yhi = w0[2 * k + 1] * bf_hi(a2[k]) + w1[2 * k + 1] * bf_hi(a1[k]) + w2[2 * k + 1] * bf_hi(a0[k]);
            r[k] = pk2(bf_lo(ab[k]) * ylo, bf_hi(ab[k]) * yhi); }
        *(u32x4*)(MIX + o) = (u32x4){r[0], r[1], r[2], r[3]}; }
}

template <unsigned MASK> __device__ __forceinline__ void mega_body(const Params& P) {
    extern __shared__ __attribute__((aligned(16))) unsigned char lds_raw[];
    LAS unsigned char* lds = (LAS unsigned char*)lds_raw;
    cg::grid_group grid = cg::this_grid();
    int ph0 = P.ph_lo;
    if (ph0 == 0) {
        if constexpr (MASK & 1u) { const int tid = threadIdx.x, lane = tid & 63, wave = __builtin_amdgcn_readfirstlane(tid >> 6); prologue(P, lds, tid, wave, lane); }
        if (P.ph_hi > 1) grid.sync();
        ph0 = 1;
    }
    for (int ph = ph0; ph < P.ph_hi; ++ph) {
        int tid_op = threadIdx.x; asm volatile("" : "+v"(tid_op));
        const int tid = tid_op, lane = tid & 63, wave = __builtin_amdgcn_readfirstlane(tid >> 6);
        unsigned char* ws = ldp<unsigned char>(P, I_WS); asm volatile("" : "+s"(ws));
        int G = gridDim.x, bid = blockIdx.x; asm volatile("" : "+s"(G), "+s"(bid));
        bf16* XB = (bf16*)(ws + WS_XB); bf16* MIX = (bf16*)(ws + WS_MIX); bf16* BIG = (bf16*)(ws + WS_BIG);
        {
            const int L = (ph - 1) / 11, k = (ph - 1) % 11;
            if (k == 0 || k == 7) { if constexpr (MASK & 2u) {
                const int lh = L * 2 + (k == 7);
                pg8::Gemm g{(L > 0 && k == 0) ? MIX : XB, (const bf16*)(ws + WS_W + (size_t)lh * W_FFN_STRIDE), S, 2 * FF, D}; pg8::StaticOrder so; so.init(S, 2 * FF, G, bid);
                pg8::EpiSwiGLU E{BIG, FF};
                pg8::gemm_phase<pg8::EpiSwiGLU, pg8::StaticOrder, true, true>(lds, g, so, E); }
            } else if (k == 1 || k == 8 || k == 5) { if constexpr (MASK & 4u) {
                pg8::Gemm g; float scale;
                if (k == 5) { g = pg8::Gemm{MIX, (const bf16*)(ws + (L == 0 ? WS_ABOUT : WS_SCOUT)), S, D, D}; scale = 1.0f; }
                else { const int lh = L * 2 + (k == 8); g = pg8::Gemm{BIG, (const bf16*)(ws + WS_W + (size_t)lh * W_FFN_STRIDE + W_FFN_DOWN), S, D, FF}; scale = 0.5f; }
                pg8::StaticOrder so; so.init(S, D, G, bid);
                pg8::EpiResid E{(ph == 2) ? ldp<const float>(P, I_X) : ldp<float>(P, I_OUT), ldp<float>(P, I_OUT), ALPHA, scale};
                pg8::gemm_phase<pg8::EpiResid, pg8::StaticOrder, true, true>(lds, g, so, E); }
            } else if (k == 2 || k == 6 || k == 9) { if constexpr (MASK & 8u) {
                const int idx = (k == 2) ? 0 : (k == 6 ? 1 : 2);
                ln_phase(ldp<float>(P, I_OUT), ldp<const float>(P, I_LNG) + (size_t)(L * 3 + idx) * D, ldp<const float>(P, I_LNB) + (size_t)(L * 3 + idx) * D, XB, wave, lane);
                if (k == 9) { const float* p = ldp<const float>(P, I_P) + (size_t)L * S * 256; bf16* PB = (bf16*)(ws + WS_BIG + 64 * MiB); const int gt = bid * (NW * 64) + tid, NGT = G * NW * 64;
                    for (int c = gt; c < S * 256 / 8; c += NGT) { const f32x4 a = *(const f32x4*)(p + (size_t)c * 8), b = *(const f32x4*)(p + (size_t)c * 8 + 4);
                        u32x4 o; o.x = pk2(a[0], a[1]); o.y = pk2(a[2], a[3]); o.z = pk2(b[0], b[1]); o.w = pk2(b[2], b[3]); *(u32x4*)(PB + (size_t)c * 8) = o; } } }
            } else if (k == 3) {
                if (L == 0) { if constexpr (MASK & 16u) { pg8::Gemm g{XB, (const bf16*)(ws + WS_ABIN), S, 1792, D}; pg8::StaticOrder so; so.init(S, 1792, G, bid);
                    pg8::EpiAB E{BIG, (const float*)(ws + WS_ROT)};
                    pg8::gemm_phase<pg8::EpiAB, pg8::StaticOrder, true, true>(lds, g, so, E); } }
                else { if constexpr (MASK & 32u) { pg8::Gemm g{XB, (const bf16*)(ws + WS_SCIN), S, 3072, D}; pg8::StaticOrder so; so.init(S, 3072, G, bid);
                    pg8::EpiSC E{BIG, BIG + (size_t)S * 1024};
                    pg8::gemm_phase<pg8::EpiSC, pg8::StaticOrder, true, true>(lds, g, so, E); } }
            } else if (k == 4) {
                if (L == 0) { if constexpr (MASK & 64u) {
                    for (int u = bid; u < 512; u += G) {
                        if (u < 256) attn_unit(lds, BIG, ldp<const float>(P, I_SINK), MIX, u >> 1, u & 1, tid, wave, lane);
                        else sgu_unit(lds, BIG, ldp<const float>(P, I_SLNG), ldp<const float>(P, I_SLNB), (const bf16*)(ws + WS_SGUW), ldp<const float>(P, I_SBS), MIX, (u - 256) >> 1, (u - 256) & 1, tid, wave, lane);
                    } }
                } else { if constexpr (MASK & 128u) conv_phase(BIG, BIG + (size_t)S * 1024, ldp<const float>(P, I_SCCW), MIX, tid); }
            } else {
                if constexpr (MASK & 256u) { float* Gt = (float*)(ws + WS_BIG);
                { pg8::Gemm g{(const bf16*)(ws + WS_BIG + 64 * MiB), (const bf16*)(ws + WS_PLEP) + (size_t)L * D * 256, S, D, 256}; pg8::StaticOrder so; so.init(S, D, G, bid);
                  pg8::EpiStoreF32 E{Gt}; pg8::gemm_phase<pg8::EpiStoreF32, pg8::StaticOrder, true, true>(lds, g, so, E); }
                { pg8::Gemm g{XB, (const bf16*)(ws + WS_PLEG) + (size_t)L * D * D, S, D, D}; pg8::StaticOrder so; so.init(S, D, G, bid);
                  pg8::EpiPLE E{ldp<float>(P, I_OUT), Gt, ldp<float>(P, I_OUT), MIX}; pg8::gemm_phase<pg8::EpiPLE, pg8::StaticOrder, true, true>(lds, g, so, E); } }
            }
        }
        if (ph + 1 < P.ph_hi) grid.sync();
    }
}

__global__ void __launch_bounds__(NW * 64, 2) mega_fwd(Params P) { mega_body<0x1ffu>(P); }
#ifdef DIAG_KINDS
__global__ void __launch_bounds__(NW * 64, 2) k_pro(Params P) { mega_body<1u>(P); }
__global__ void __launch_bounds__(NW * 64, 2) k_up(Params P) { mega_body<2u>(P); }
__global__ void __launch_bounds__(NW * 64, 2) k_res(Params P) { mega_body<4u>(P); }
__global__ void __launch_bounds__(NW * 64, 2) k_ln(Params P) { mega_body<8u>(P); }
__global__ void __launch_bounds__(NW * 64, 2) k_ab(Params P) { mega_body<16u>(P); }
__global__ void __launch_bounds__(NW * 64, 2) k_sc(Params P) { mega_body<32u>(P); }
__global__ void __launch_bounds__(NW * 64, 2) k_mix(Params P) { mega_body<64u>(P); }
__global__ void __launch_bounds__(NW * 64, 2) k_conv(Params P) { mega_body<128u>(P); }
__global__ void __launch_bounds__(NW * 64, 2) k_ple(Params P) { mega_body<256u>(P); }
#endif
#ifndef ONE_LAUNCH
#define ONE_LAUNCH 1
#endif
extern "C" void kernel_launch(void* const* d_in, const int* in_sizes, int n_in, void* d_out, int out_size, void* d_ws, size_t ws_size, hipStream_t stream) {
    static int grid = 0;
    if (grid == 0) {
        int dev = 0, cus = 0, per_cu = 0;
        hipGetDevice(&dev); hipDeviceGetAttribute(&cus, hipDeviceAttributeMultiprocessorCount, dev);
        hipFuncSetAttribute((const void*)mega_fwd, hipFuncAttributeMaxDynamicSharedMemorySize, LDS_BYTES);
        hipOccupancyMaxActiveBlocksPerMultiprocessor(&per_cu, (const void*)mega_fwd, NW * 64, LDS_BYTES);
        if (per_cu < 1) { fprintf(stderr, "kernel_launch: occupancy query reports %d blocks per CU\n", per_cu); per_cu = 1; }
        (void)hipGetLastError();
        grid = cus;
        if (ws_size < WS_END) fprintf(stderr, "kernel_launch: workspace too small: %zu < %zu\n", ws_size, (size_t)WS_END);
    }
    {
        const long long exp_sizes[20] = {16777216LL, 8388608LL, 16384LL, 6144LL, 6144LL, 11534336LL, 11534336LL, 11534336LL, 1835008LL, 8LL, 512LL, 512LL, 131072LL, 1024LL, 1048576LL, 3145728LL, 3072LL, 1048576LL, 524288LL, 2097152LL};
        bool ok = (n_in == 20) && (out_size == 16777216) && (ws_size >= WS_END);
        for (int i = 0; ok && i < 20; ++i) ok = ((long long)in_sizes[i] == exp_sizes[i]);
        if (!ok) { fprintf(stderr, "kernel_launch: unexpected shapes / workspace (n_in %d, out %d, ws %zu)\n", n_in, out_size, ws_size); return; }
    }
    Params P{};
    for (int i = 0; i < 20; ++i) P.ptr[i] = d_in[i];
    P.ptr[I_OUT] = d_out; P.ptr[I_WS] = d_ws;
#if ONE_LAUNCH
    P.ph_lo = 0; P.ph_hi = NPHASE;
    void* args[] = {&P};
    hipError_t e = hipLaunchCooperativeKernel((const void*)mega_fwd, dim3(grid), dim3(NW * 64), args, LDS_BYTES, stream);
    if (e != hipSuccess) fprintf(stderr, "cooperative launch failed: %s (grid %d)\n", hipGetErrorString(e), grid);
#else
#ifndef RUN_PHASES
#define RUN_PHASES NPHASE
#endif
    for (int ph = 0; ph < RUN_PHASES; ++ph) { P.ph_lo = ph; P.ph_hi = ph + 1;
        hipLaunchKernelGGL(mega_fwd, dim3(grid), dim3(NW * 64), LDS_BYTES, stream, P); }
#endif
}
```
